# Optimizing an MI355X kernel written in HIP

```python
import jax, jax.numpy as jnp
from jax import lax
import numpy as np

D_MODEL = 2048
BATCH = 16
SEQ = 2048
DEPTH = 1
DEC_BATCH = 2
DEC_SEQ = 8192
PAST_LEN = 128

HEAD_DIM = 128
N_Q_HEADS = 8
N_KV_HEADS = 2
GQA_GROUP = N_Q_HEADS // N_KV_HEADS
D_ATTN = N_Q_HEADS * HEAD_DIM
D_KV = N_KV_HEADS * HEAD_DIM
WINDOW = 128
BLOCK = 128
D_CONV = D_MODEL // 4
CONV_WIDTH = 3
N_MEM = 256
N_X_HEADS = 4
D_XATTN = N_X_HEADS * HEAD_DIM
D_MIX = D_ATTN + D_CONV + D_XATTN
IN_SIZES = (D_ATTN, D_KV, D_KV, D_CONV, D_CONV, D_CONV, D_XATTN)
D_IN = sum(IN_SIZES)
N_BRANCH = 3
D_FF = 5504
N_BUCKETS = 32
MAX_DISTANCE = 128
LN_EPS = 1e-5
NEG_INF = -1e30
ALPHA = (2 * DEPTH) ** 0.25
BETA = (8 * DEPTH) ** -0.25

kernel_name = "hybrid_gated_window_conv_memory_encoder"


def _band_geometry():
    t = np.arange(BLOCK)[:, None]
    j = np.arange(3 * BLOCK)[None, :]
    rel = j - BLOCK - t
    half = N_BUCKETS // 2
    max_exact = half // 2
    n = np.abs(rel)
    large = max_exact + (np.log(np.maximum(n, 1) / max_exact) / np.log(MAX_DISTANCE / max_exact) * (half - max_exact)).astype(np.int32)
    large = np.minimum(large, half - 1)
    bucket = (rel > 0).astype(np.int32) * half + np.where(n < max_exact, n, large)
    return rel, bucket.astype(np.int32)


def _layer_norm(x, g, b):
    xf = x.astype(jnp.float32)
    mu = xf.mean(-1, keepdims=True)
    var = jnp.square(xf - mu).mean(-1, keepdims=True)
    return ((xf - mu) * lax.rsqrt(var + LN_EPS) * g.astype(jnp.float32) + b.astype(jnp.float32)).astype(x.dtype)


def _swiglu(x, w_gate_up, w_down):
    g, u = jnp.split(x @ w_gate_up, 2, axis=-1)
    return (jax.nn.silu(g) * u) @ w_down


def _window_attention(q, k, v, rel_bias, sink):
    B, S = q.shape[:2]
    n = S // BLOCK
    qb = q.reshape(B, n, BLOCK, N_KV_HEADS, GQA_GROUP, HEAD_DIM)

    def band(t):
        tp = jnp.pad(t, ((0, 0), (BLOCK, BLOCK), (0, 0), (0, 0))).reshape(B, n + 2, BLOCK, N_KV_HEADS, HEAD_DIM)
        return jnp.concatenate([tp[:, :-2], tp[:, 1:-1], tp[:, 2:]], axis=2)

    kb, vb = band(k), band(v)
    s = jnp.einsum('bnqhgd,bnkhd->bnhgqk', qb, kb, preferred_element_type=jnp.float32) * (HEAD_DIM ** -0.5)
    s = s + rel_bias.reshape(1, 1, N_KV_HEADS, GQA_GROUP, BLOCK, 3 * BLOCK)
    rel, _ = _band_geometry()
    kpos = (np.arange(n)[:, None] - 1) * BLOCK + np.arange(3 * BLOCK)[None, :]
    valid = (np.abs(rel) <= WINDOW)[None] & ((kpos >= 0) & (kpos < S))[:, None, :]
    s = jnp.where(valid[None, :, None, None], s, NEG_INF)
    sink_l = sink.astype(jnp.float32).reshape(1, 1, N_KV_HEADS, GQA_GROUP, 1, 1)
    m = jnp.maximum(s.max(-1, keepdims=True), sink_l)
    p = jnp.exp(s - m)
    p = (p / (p.sum(-1, keepdims=True) + jnp.exp(sink_l - m))).astype(v.dtype)
    o = jnp.einsum('bnhgqk,bnkhd->bnqhgd', p, vb)
    return o.reshape(B, S, D_ATTN)


def _short_conv(u, w):
    up = jnp.pad(u, ((0, 0), (1, 1), (0, 0)))
    return up[:, :-2] * w[0] + up[:, 1:-1] * w[1] + up[:, 2:] * w[2]


def _memory_attention(q, mem, w_mem_kv):
    B, S = q.shape[:2]
    kv = (mem @ w_mem_kv).reshape(B, N_MEM, 2, N_X_HEADS, HEAD_DIM)
    s = jnp.einsum('bshd,bmhd->bhsm', q, kv[:, :, 0], preferred_element_type=jnp.float32) * (HEAD_DIM ** -0.5)
    p = jax.nn.softmax(s, axis=-1).astype(q.dtype)
    return jnp.einsum('bhsm,bmhd->bshd', p, kv[:, :, 1]).reshape(B, S, D_XATTN)


def _layer(x, mem, rel_bias, ln1_g, ln1_b, ffn1_w_gate_up, ffn1_w_down, w_in, conv_w, w_mem_kv,
           attn_sink, w_gate, b_gate, w_branch, w_o, ln2_g, ln2_b, ffn2_w_gate_up, ffn2_w_down, ln3_g, ln3_b):
    B, S, _ = x.shape
    x = _layer_norm(ALPHA * x + 0.5 * _swiglu(x, ffn1_w_gate_up, ffn1_w_down), ln1_g, ln1_b)
    cuts = list(np.cumsum(IN_SIZES)[:-1])
    q, k, v, cb, cc, ch, qx = jnp.split(x @ w_in, cuts, axis=-1)
    y_attn = _window_attention(q.reshape(B, S, N_Q_HEADS, HEAD_DIM), k.reshape(B, S, N_KV_HEADS, HEAD_DIM),
                               v.reshape(B, S, N_KV_HEADS, HEAD_DIM), rel_bias, attn_sink)
    y_conv = cb * _short_conv(cc * ch, conv_w)
    y_mem = _memory_attention(qx.reshape(B, S, N_X_HEADS, HEAD_DIM), mem, w_mem_kv)
    gates = jax.nn.sigmoid(x @ w_gate + b_gate).reshape(B, S, N_BRANCH, D_MODEL)
    merged = (gates[:, :, 0] * (y_attn @ w_branch[:D_ATTN])
              + gates[:, :, 1] * (y_conv @ w_branch[D_ATTN:D_ATTN + D_CONV])
              + gates[:, :, 2] * (y_mem @ w_branch[D_ATTN + D_CONV:]))
    x = _layer_norm(ALPHA * x + merged @ w_o, ln2_g, ln2_b)
    x = _layer_norm(ALPHA * x + 0.5 * _swiglu(x, ffn2_w_gate_up, ffn2_w_down), ln3_g, ln3_b)
    return x


def _forward(x, mem, rel_bias, ln1_g, ln1_b, ffn1_w_gate_up, ffn1_w_down, w_in, conv_w, w_mem_kv,
             attn_sink, w_gate, b_gate, w_branch, w_o, ln2_g, ln2_b, ffn2_w_gate_up, ffn2_w_down, ln3_g, ln3_b):
    for l in range(DEPTH):
        x = _layer(x, mem, rel_bias, ln1_g[l], ln1_b[l], ffn1_w_gate_up[l], ffn1_w_down[l], w_in[l], conv_w[l],
                   w_mem_kv[l], attn_sink[l], w_gate[l], b_gate[l], w_branch[l], w_o[l], ln2_g[l], ln2_b[l],
                   ffn2_w_gate_up[l], ffn2_w_down[l], ln3_g[l], ln3_b[l])
    return x


def setup_inputs(seed: int = 0) -> dict:
    key = jax.random.key(seed)
    ks = jax.random.split(key, 24)
    f32 = jnp.float32
    nrm = lambda k, shape, s: jax.random.normal(k, shape, f32) * s
    L = DEPTH
    return {
        "x_prompt": nrm(ks[0], (BATCH, SEQ, D_MODEL), 1.0),
        "x_sample": nrm(ks[1], (DEC_BATCH, DEC_SEQ, D_MODEL), 1.0),
        "mem_prompt": nrm(ks[2], (BATCH, N_MEM, D_MODEL), 1.0),
        "mem_sample": nrm(ks[3], (DEC_BATCH, N_MEM, D_MODEL), 1.0),
        "rel_bias_table": nrm(ks[4], (N_BUCKETS, N_Q_HEADS), 0.5),
        "ln1_g": 1.0 + nrm(ks[5], (L, D_MODEL), 0.02),
        "ln1_b": nrm(ks[6], (L, D_MODEL), 0.02),
        "ffn1_w_gate_up": nrm(ks[7], (L, D_MODEL, 2 * D_FF), D_MODEL ** -0.5),
        "ffn1_w_down": nrm(ks[8], (L, D_FF, D_MODEL), BETA * D_FF ** -0.5),
        "w_in": nrm(ks[9], (L, D_MODEL, D_IN), D_MODEL ** -0.5),
        "conv_w": nrm(ks[10], (L, CONV_WIDTH, D_CONV), CONV_WIDTH ** -0.5),
        "w_mem_kv": nrm(ks[11], (L, D_MODEL, 2 * D_XATTN), D_MODEL ** -0.5),
        "attn_sink": nrm(ks[12], (L, N_Q_HEADS), 0.5),
        "w_gate": nrm(ks[13], (L, D_MODEL, N_BRANCH * D_MODEL), D_MODEL ** -0.5),
        "b_gate": nrm(ks[14], (L, N_BRANCH * D_MODEL), 0.1),
        "w_branch": nrm(ks[15], (L, D_MIX, D_MODEL), BETA * D_MIX ** -0.5),
        "w_o": nrm(ks[16], (L, D_MODEL, D_MODEL), BETA * D_MODEL ** -0.5),
        "ln2_g": 1.0 + nrm(ks[17], (L, D_MODEL), 0.02),
        "ln2_b": nrm(ks[18], (L, D_MODEL), 0.02),
        "ffn2_w_gate_up": nrm(ks[19], (L, D_MODEL, 2 * D_FF), D_MODEL ** -0.5),
        "ffn2_w_down": nrm(ks[20], (L, D_FF, D_MODEL), BETA * D_FF ** -0.5),
        "ln3_g": 1.0 + nrm(ks[21], (L, D_MODEL), 0.02),
        "ln3_b": nrm(ks[22], (L, D_MODEL), 0.02),
    }


def reference(x_prompt, x_sample, mem_prompt, mem_sample, rel_bias_table, ln1_g, ln1_b, ffn1_w_gate_up,
              ffn1_w_down, w_in, conv_w, w_mem_kv, attn_sink, w_gate, b_gate, w_branch, w_o, ln2_g, ln2_b,
              ffn2_w_gate_up, ffn2_w_down, ln3_g, ln3_b):
    _, bucket = _band_geometry()
    rel_bias = jnp.transpose(rel_bias_table[bucket], (2, 0, 1)).astype(jnp.float32)
    weights = (ln1_g, ln1_b, ffn1_w_gate_up, ffn1_w_down, w_in, conv_w, w_mem_kv, attn_sink, w_gate, b_gate,
               w_branch, w_o, ln2_g, ln2_b, ffn2_w_gate_up, ffn2_w_down, ln3_g, ln3_b)
    y_prompt = _forward(x_prompt, mem_prompt, rel_bias, *weights)
    y_sample = _forward(x_sample, mem_sample, rel_bias, *weights)
    return (y_prompt, y_sample)
```

```cpp
#include <hip/hip_runtime.h>
#include <hip/hip_cooperative_groups.h>
#include <cstdio>
#include <cstdint>
namespace cg = cooperative_groups;

#define LAS __attribute__((address_space(3)))
typedef unsigned short bf16_t;
typedef short bf16x8 __attribute__((ext_vector_type(8)));
typedef short s16x4 __attribute__((ext_vector_type(4)));
typedef float f32x4 __attribute__((ext_vector_type(4)));
typedef float f32x16 __attribute__((ext_vector_type(16)));
typedef unsigned u32x4 __attribute__((ext_vector_type(4)));
typedef unsigned u32x2 __attribute__((ext_vector_type(2)));
typedef __bf16 nbf16x2 __attribute__((ext_vector_type(2)));
typedef float f32x2 __attribute__((ext_vector_type(2)));

constexpr int D = 2048, T_P = 16 * 2048, T_S = 2 * 8192, T = T_P + T_S;
constexpr int SEQ_P = 2048, SEQ_S = 8192;
constexpr int DFF = 5504, NGU = 2 * DFF;
constexpr int DIN = 3584, NGATE = 3 * D, NIG = DIN + NGATE;
constexpr int NMEM = 256, MEM_ROWS = 18 * NMEM, DMKV = 1024;
constexpr int CH_ROWS = 24576, NCHUNK = 2;
constexpr float ALPHA = 1.189207115002721f;
constexpr float LN_EPS = 1e-5f;
constexpr float LOG2E = 1.4426950408889634f;
constexpr int C_Q = 0, C_K = 1024, C_V = 1280, C_CB = 1536, C_CC = 2048, C_CH = 2560, C_QX = 3072;

constexpr size_t MiB = 1u << 20;
constexpr size_t WS_WGU1 = 1 * MiB, WS_WD1 = 44 * MiB, WS_WGU2 = 65 * MiB + MiB / 2, WS_WD2 = 108 * MiB + MiB / 2, WS_WIG = 130 * MiB, WS_WMKV = 168 * MiB,
                 WS_WBR = 172 * MiB, WS_WO = 180 * MiB, WS_MEMB = 188 * MiB, WS_MEMKV = 206 * MiB, WS_XB = 216 * MiB, WS_BIG = 408 * MiB, WS_END = 960 * MiB;
constexpr size_t BIG_H = 0, BIG_QKV = 0, BIG_G = 168 * MiB, BIG_YMIX = 456 * MiB, BIG_MERGED = 0;
static_assert((size_t)T * DFF * 2 <= 552 * MiB && (size_t)CH_ROWS * DIN * 2 == 168 * MiB && (size_t)CH_ROWS * NGATE * 2 == 288 * MiB && (size_t)CH_ROWS * D * 2 == 96 * MiB, "ws map");

constexpr int LDS_BYTES = 147456;

__device__ __forceinline__ unsigned pk2(float lo, float hi) { f32x2 v = {lo, hi}; nbf16x2 b = __builtin_convertvector(v, nbf16x2); return __builtin_bit_cast(unsigned, b); }
__device__ __forceinline__ float bf_lo(unsigned w) { return __builtin_bit_cast(float, w << 16); }
__device__ __forceinline__ float bf_hi(unsigned w) { return __builtin_bit_cast(float, w & 0xffff0000u); }
__device__ __forceinline__ float fast_exp2(float x) { return __builtin_amdgcn_exp2f(x); }
__device__ __forceinline__ float fast_rcp(float x) { return __builtin_amdgcn_rcpf(x); }
__device__ __forceinline__ float sigmoidf_(float x) { return fast_rcp(1.0f + fast_exp2(-x * LOG2E)); }

namespace pg8 {
constexpr int BM = 256, BK = 64, HALF = 128, HTB = HALF * BK * 2, STAGE_BYTES = 8 * HTB, NXCD = 8, WGM = 8;
__host__ __device__ __forceinline__ int lds_byte(int r, int c) { const int st = (r >> 4) * 2 + (c >> 5), rr = r & 15, cc = c & 31, ob = rr * 64 + cc * 2; return st * 1024 + (ob ^ (((ob >> 9) & 1) << 5)); }
__host__ __device__ __forceinline__ void stage_rc(int b, int& R, int& C) { const int st = b / 1024, sb = b % 1024, swz = sb ^ (((sb >> 9) & 1) << 5); R = (st >> 1) * 16 + swz / 64; C = (st & 1) * 32 + (swz % 64) / 2; }
__host__ __device__ __forceinline__ int perm32(int rho) { const int n = rho >> 4, i = rho & 15; return 8 * (i >> 2) + 4 * n + (i & 3); }

struct Unit { int pm, pn; };
struct Gemm { const bf16_t* A; const bf16_t* Bt; int lda, ldb, M, N, K; };

struct StaticOrder {
    int nM, nN, nwg, G, c;
    __device__ void init(int M, int N, int G_, int c_) { nM = M / BM; nN = N / BM; nwg = nM * nN; G = G_; asm volatile("" : "+s"(c_)); c = c_; }
    __device__ bool next(int i, Unit& u) const {
        if (c < 0 || c >= G) return false;
        const long L = (long)i * G + c; if (L >= nwg) return false;
        int wgid = (int)L; { const int q = nwg / NXCD, r = nwg % NXCD, xcd = wgid % NXCD, off = wgid / NXCD; wgid = (xcd < r ? xcd * (q + 1) : r * (q + 1) + (xcd - r) * q) + off; }
        const int nig = WGM * nN, gid = wgid / nig, fm = gid * WGM, gsz = (nM - fm) < WGM ? (nM - fm) : WGM;
        u.pm = fm + ((wgid % nig) % gsz); u.pn = (wgid % nig) / gsz; return true;
    }
};

typedef f32x4 Acc[2][2][4][2];

struct EpiSwiGLU {
    static constexpr bool PERM = true;
    bf16_t* H;
    __device__ __forceinline__ void operator()(const Acc& acc, const Unit& u, int wr, int wc, int fr, int fq) const {
        const int row0 = u.pm * BM + wr * 64 + fr, col0 = u.pn * HALF + wc * 32 + 8 * fq;
#pragma unroll
        for (int ai = 0; ai < 2; ++ai)
#pragma unroll
            for (int m = 0; m < 4; ++m) {
                bf16_t* rowp = H + (size_t)(row0 + ai * HALF + m * 16) * DFF + col0;
                float o[8];
#pragma unroll
                for (int n = 0; n < 2; ++n)
#pragma unroll
                    for (int j = 0; j < 4; ++j) { const float g = acc[ai][0][m][n][j], up = acc[ai][1][m][n][j]; o[4 * n + j] = g * sigmoidf_(g) * up; }
                u32x4 w; w.x = pk2(o[0], o[1]); w.y = pk2(o[2], o[3]); w.z = pk2(o[4], o[5]); w.w = pk2(o[6], o[7]);
                *(u32x4*)rowp = w;
            }
    }
};
struct EpiBf16 {
    static constexpr bool PERM = true;
    bf16_t* O; int ldc;
    __device__ __forceinline__ void operator()(const Acc& acc, const Unit& u, int wr, int wc, int fr, int fq) const {
        const int row0 = u.pm * BM + wr * 64 + fr, col0 = u.pn * BM + wc * 32 + 8 * fq;
#pragma unroll
        for (int ai = 0; ai < 2; ++ai)
#pragma unroll
            for (int m = 0; m < 4; ++m) { bf16_t* rowp = O + (size_t)(row0 + ai * HALF + m * 16) * ldc + col0;
#pragma unroll
                for (int bj = 0; bj < 2; ++bj) { const f32x4 v0 = acc[ai][bj][m][0], v1 = acc[ai][bj][m][1];
                    u32x4 w; w.x = pk2(v0[0], v0[1]); w.y = pk2(v0[2], v0[3]); w.z = pk2(v1[0], v1[1]); w.w = pk2(v1[2], v1[3]);
                    *(u32x4*)(rowp + bj * HALF) = w; } }
    }
};
struct EpiInGate {
    static constexpr bool PERM = true;
    bf16_t* QKV; bf16_t* G; const float* bgate;
    __device__ __forceinline__ void operator()(const Acc& acc, const Unit& u, int wr, int wc, int fr, int fq) const {
        const int row0 = u.pm * BM + wr * 64 + fr; const int colt = u.pn * BM;
        if (colt < DIN) {
            const int col0 = colt + wc * 32 + 8 * fq;
#pragma unroll
            for (int ai = 0; ai < 2; ++ai)
#pragma unroll
                for (int m = 0; m < 4; ++m) { bf16_t* rowp = QKV + (size_t)(row0 + ai * HALF + m * 16) * DIN + col0;
#pragma unroll
                    for (int bj = 0; bj < 2; ++bj) { const f32x4 v0 = acc[ai][bj][m][0], v1 = acc[ai][bj][m][1];
                        u32x4 w; w.x = pk2(v0[0], v0[1]); w.y = pk2(v0[2], v0[3]); w.z = pk2(v1[0], v1[1]); w.w = pk2(v1[2], v1[3]);
                        *(u32x4*)(rowp + bj * HALF) = w; } }
        } else {
            const int col0 = colt - DIN + wc * 32 + 8 * fq;
#pragma unroll
            for (int bj = 0; bj < 2; ++bj) {
                const f32x4 bv0 = *(const f32x4*)(bgate + col0 + bj * HALF), bv1 = *(const f32x4*)(bgate + col0 + bj * HALF + 4);
#pragma unroll
                for (int ai = 0; ai < 2; ++ai)
#pragma unroll
                    for (int m = 0; m < 4; ++m) { bf16_t* rowp = G + (size_t)(row0 + ai * HALF + m * 16) * NGATE + col0;
                        const f32x4 v0 = acc[ai][bj][m][0] + bv0, v1 = acc[ai][bj][m][1] + bv1;
                        u32x4 w; w.x = pk2(sigmoidf_(v0[0]), sigmoidf_(v0[1])); w.y = pk2(sigmoidf_(v0[2]), sigmoidf_(v0[3]));
                        w.z = pk2(sigmoidf_(v1[0]), sigmoidf_(v1[1])); w.w = pk2(sigmoidf_(v1[2]), sigmoidf_(v1[3]));
                        *(u32x4*)(rowp + bj * HALF) = w; }
                asm volatile("" ::: "memory"); }
        }
    }
};
struct EpiBranch {
    static constexpr bool PERM = true;
    const bf16_t* G; bf16_t* Mg; int b;
    __device__ __forceinline__ void operator()(const Acc& acc, const Unit& u, int wr, int wc, int fr, int fq) const {
        const int row0 = u.pm * BM + wr * 64 + fr, col0 = u.pn * BM + wc * 32 + 8 * fq;
#pragma unroll
        for (int ai = 0; ai < 2; ++ai)
#pragma unroll
            for (int m = 0; m < 4; ++m) { const size_t row = (size_t)(row0 + ai * HALF + m * 16);
#pragma unroll
                for (int bj = 0; bj < 2; ++bj) {
                    const u32x4 gw = *(const u32x4*)(G + row * NGATE + b * D + col0 + bj * HALF);
                    u32x4 pw = {0u, 0u, 0u, 0u};
                    if (b > 0) pw = *(const u32x4*)(Mg + row * D + col0 + bj * HALF);
                    const f32x4 v0 = acc[ai][bj][m][0], v1 = acc[ai][bj][m][1];
                    u32x4 w;
                    w.x = pk2(bf_lo(pw.x) + bf_lo(gw.x) * v0[0], bf_hi(pw.x) + bf_hi(gw.x) * v0[1]);
                    w.y = pk2(bf_lo(pw.y) + bf_lo(gw.y) * v0[2], bf_hi(pw.y) + bf_hi(gw.y) * v0[3]);
                    w.z = pk2(bf_lo(pw.z) + bf_lo(gw.z) * v1[0], bf_hi(pw.z) + bf_hi(gw.z) * v1[1]);
                    w.w = pk2(bf_lo(pw.w) + bf_lo(gw.w) * v1[2], bf_hi(pw.w) + bf_hi(gw.w) * v1[3]);
                    *(u32x4*)(Mg + row * D + col0 + bj * HALF) = w;
                    asm volatile("" ::: "memory"); } }
    }
};
struct EpiRes {
    static constexpr bool PERM = false;
    const float* res0; const float* res1; int split; float* out; float scale; int row_off;
    __device__ __forceinline__ void operator()(const Acc& acc, const Unit& u, int wr, int wc, int fr, int fq) const {
        const int row0 = row_off + u.pm * BM + wr * 64 + fr, col0 = u.pn * BM + wc * 32 + 4 * fq;
#pragma unroll
        for (int ai = 0; ai < 2; ++ai)
#pragma unroll
            for (int m = 0; m < 4; ++m) { const int row = row0 + ai * HALF + m * 16;
                const float* rp = (row < split ? res0 + (size_t)row * D : res1 + (size_t)(row - split) * D) + col0; float* op = out + (size_t)row * D + col0;
#pragma unroll
                for (int bj = 0; bj < 2; ++bj)
#pragma unroll
                    for (int n = 0; n < 2; ++n) { const f32x4 r = *(const f32x4*)(rp + bj * HALF + n * 16); *(f32x4*)(op + bj * HALF + n * 16) = r * ALPHA + acc[ai][bj][m][n] * scale; }
                asm volatile("" ::: "memory"); }
    }
};

template <class Epi, class Sched, bool ALIGN_EPI, bool SP2>
__device__ __forceinline__ void gemm_phase(LAS unsigned char* lds, const Gemm g, const Sched& S, const Epi& E) {
    int tid_ = threadIdx.x; asm volatile("" : "+v"(tid_));
    const int tid = tid_, wid = __builtin_amdgcn_readfirstlane(tid >> 6), lane = tid & 63, wr = wid >> 2, wc = wid & 3, fr = lane & 15, fq = lane >> 4;
    const int K = g.K, nt = K / BK;
    unsigned voffA[2], voffB[2];
#pragma unroll
    for (int i = 0; i < 2; ++i) { int R, C; stage_rc(tid * 16 + i * 8192, R, C); const int Rb = Epi::PERM ? ((R & ~31) + perm32(R & 31)) : R;
        voffA[i] = (unsigned)(R * g.lda + C) * 2u; voffB[i] = (unsigned)(Rb * g.ldb + C) * 2u; }
    const size_t kstep = (size_t)(BK * 2);
    const size_t hstepA = (size_t)HALF * g.lda * 2, hstepB = (size_t)HALF * g.ldb * 2;
    const size_t tstepA = 2 * hstepA, tstepB = 2 * hstepB;
    const unsigned ldsw = (unsigned)wid * 1024u;
    const int aoff = lds_byte(wr * 64 + fr, fq * 8), boff = lds_byte(wc * 32 + fr, fq * 8);
#define PG8_SA(b, h) (((b) * 2 + (h)) * HTB)
#define PG8_SB(b, h) ((4 + (b) * 2 + (h)) * HTB)
#define PG8_STAGE(bufoff, gbase, voff) do { _Pragma("unroll") for (int _i = 0; _i < 2; ++_i) \
        __builtin_amdgcn_global_load_lds((const unsigned*)((const char*)(gbase) + (voff)[_i]), (LAS unsigned*)(lds + (bufoff) + ldsw + _i * 8192), 16, 0, 0); } while (0)
#define PG8_LDA(dst, b, h) do { _Pragma("unroll") for (int m = 0; m < 4; ++m) _Pragma("unroll") for (int k = 0; k < 2; ++k) dst[m][k] = *(const LAS bf16x8*)(lds + PG8_SA(b, h) + aoff + m * 2048 + k * 1024); } while (0)
#define PG8_LDB(dst, b, h) do { _Pragma("unroll") for (int n = 0; n < 2; ++n) _Pragma("unroll") for (int k = 0; k < 2; ++k) dst[n][k] = *(const LAS bf16x8*)(lds + PG8_SB(b, h) + boff + n * 2048 + k * 1024); } while (0)
#define PG8_MMA(ai, bj, At, Bt) do { __builtin_amdgcn_s_setprio(1); _Pragma("unroll") for (int m = 0; m < 4; ++m) _Pragma("unroll") for (int n = 0; n < 2; ++n) _Pragma("unroll") for (int k = 0; k < 2; ++k) \
        acc[ai][bj][m][n] = __builtin_amdgcn_mfma_f32_16x16x32_bf16(Bt[n][k], At[m][k], acc[ai][bj][m][n], 0, 0, 0); __builtin_amdgcn_s_setprio(0); } while (0)
#define PG8_WAIT_V(n) asm volatile("s_waitcnt vmcnt(" #n ")" ::: "memory")
#define PG8_WAIT_L(n) asm volatile("s_waitcnt lgkmcnt(" #n ")" ::: "memory")
#define PG8_BAR __builtin_amdgcn_s_barrier()
#define PG8_SCHED __builtin_amdgcn_sched_barrier(0)
    Unit cur, nxt; int ui = 0;
    if (!S.next(0, cur)) return;
    f32x4 acc[2][2][4][2];
#pragma unroll
    for (int a = 0; a < 2; ++a)
#pragma unroll
        for (int b = 0; b < 2; ++b)
#pragma unroll
            for (int m = 0; m < 4; ++m)
#pragma unroll
                for (int n = 0; n < 2; ++n) acc[a][b][m][n] = (f32x4){0.f, 0.f, 0.f, 0.f};
    bf16x8 At[4][2], B0[2][2], B1[2][2];
    const char* cA = (const char*)g.A + (size_t)cur.pm * tstepA; const char* cB = (const char*)g.Bt + (size_t)cur.pn * tstepB;
    if constexpr (SP2) {
        PG8_STAGE(PG8_SB(0, 0), cB, voffB); PG8_STAGE(PG8_SB(0, 1), cB + hstepB, voffB); PG8_STAGE(PG8_SA(0, 0), cA, voffA); PG8_STAGE(PG8_SA(0, 1), cA + hstepA, voffA);
        if (wr == 1) PG8_BAR;
        PG8_WAIT_V(2); PG8_BAR;
        PG8_STAGE(PG8_SB(1, 0), cB + kstep, voffB); PG8_STAGE(PG8_SA(1, 0), cA + kstep, voffA); PG8_STAGE(PG8_SB(1, 1), cB + hstepB + kstep, voffB);
        PG8_WAIT_V(6); PG8_BAR;
    } else {
        PG8_STAGE(PG8_SB(0, 0), cB, voffB); PG8_STAGE(PG8_SA(0, 0), cA, voffA); PG8_STAGE(PG8_SB(0, 1), cB + hstepB, voffB); PG8_STAGE(PG8_SA(0, 1), cA + hstepA, voffA);
        if (wr == 1) PG8_BAR;
        PG8_WAIT_V(4); PG8_BAR;
        PG8_STAGE(PG8_SB(1, 0), cB + kstep, voffB); PG8_STAGE(PG8_SA(1, 0), cA + kstep, voffA); PG8_STAGE(PG8_SB(1, 1), cB + hstepB + kstep, voffB);
        PG8_WAIT_V(6); PG8_BAR;
    }
    for (;;) {
        const bool has_next = S.next(ui + 1, nxt);
        const char* nA = has_next ? (const char*)g.A + (size_t)nxt.pm * tstepA : cA; const char* nB = has_next ? (const char*)g.Bt + (size_t)nxt.pn * tstepB : cB;
        for (int t = 0; t < nt; t += 2) {
            const bool last = (t == nt - 2);
            const char* a1 = cA + (size_t)(t + 1) * kstep;
            const char* a2 = last ? nA : cA + (size_t)(t + 2) * kstep; const char* b2 = last ? nB : cB + (size_t)(t + 2) * kstep;
            const char* a3 = a2 + kstep; const char* b3 = b2 + kstep;
            if constexpr (SP2) {
            PG8_LDB(B0, 0, 0); PG8_LDB(B1, 0, 1); PG8_SCHED; PG8_LDA(At, 0, 0); PG8_STAGE(PG8_SA(1, 1), a1 + hstepA, voffA);
            PG8_WAIT_V(8); PG8_WAIT_L(0); PG8_BAR; PG8_MMA(0, 0, At, B0); PG8_MMA(0, 1, At, B1); PG8_BAR; PG8_SCHED;
            PG8_LDA(At, 0, 1); PG8_STAGE(PG8_SB(0, 0), b2, voffB); PG8_STAGE(PG8_SB(0, 1), b2 + hstepB, voffB); PG8_STAGE(PG8_SA(0, 0), a2, voffA);
            PG8_WAIT_V(8); PG8_WAIT_L(0); PG8_BAR; PG8_MMA(1, 0, At, B0); PG8_MMA(1, 1, At, B1); PG8_BAR; PG8_SCHED;
            PG8_LDB(B0, 1, 0); PG8_LDB(B1, 1, 1); PG8_SCHED; PG8_LDA(At, 1, 0); PG8_STAGE(PG8_SA(0, 1), a2 + hstepA, voffA);
            PG8_WAIT_V(8); PG8_WAIT_L(0); PG8_BAR; PG8_MMA(0, 0, At, B0); PG8_MMA(0, 1, At, B1); PG8_BAR; PG8_SCHED;
            PG8_LDA(At, 1, 1); PG8_STAGE(PG8_SB(1, 0), b3, voffB); PG8_STAGE(PG8_SB(1, 1), b3 + hstepB, voffB); PG8_STAGE(PG8_SA(1, 0), a3, voffA);
            PG8_WAIT_V(8); PG8_WAIT_L(0); PG8_BAR; PG8_MMA(1, 0, At, B0); PG8_MMA(1, 1, At, B1); PG8_BAR; PG8_SCHED;
            } else {
            PG8_LDB(B0, 0, 0); PG8_SCHED; PG8_LDA(At, 0, 0); PG8_STAGE(PG8_SA(1, 1), a1 + hstepA, voffA);
            PG8_WAIT_L(8); PG8_BAR; PG8_WAIT_L(0); PG8_MMA(0, 0, At, B0); PG8_BAR; PG8_SCHED;
            PG8_LDB(B1, 0, 1); PG8_STAGE(PG8_SB(0, 0), b2, voffB);
            PG8_BAR; PG8_WAIT_L(0); PG8_MMA(0, 1, At, B1); PG8_BAR;
            PG8_LDA(At, 0, 1); PG8_STAGE(PG8_SA(0, 0), a2, voffA);
            PG8_BAR; PG8_WAIT_L(0); PG8_MMA(1, 0, At, B0); PG8_BAR; PG8_SCHED;
            PG8_STAGE(PG8_SB(0, 1), b2 + hstepB, voffB);
            PG8_WAIT_V(6); PG8_BAR; PG8_MMA(1, 1, At, B1); PG8_BAR;
            PG8_LDB(B0, 1, 0); PG8_SCHED; PG8_LDA(At, 1, 0); PG8_STAGE(PG8_SA(0, 1), a2 + hstepA, voffA);
            PG8_WAIT_L(8); PG8_BAR; PG8_WAIT_L(0); PG8_MMA(0, 0, At, B0); PG8_BAR; PG8_SCHED;
            PG8_LDB(B1, 1, 1); PG8_STAGE(PG8_SB(1, 0), b3, voffB);
            PG8_BAR; PG8_WAIT_L(0); PG8_MMA(0, 1, At, B1); PG8_BAR;
            PG8_LDA(At, 1, 1); PG8_STAGE(PG8_SA(1, 0), a3, voffA);
            PG8_BAR; PG8_WAIT_L(0); PG8_MMA(1, 0, At, B0); PG8_BAR; PG8_SCHED;
            PG8_STAGE(PG8_SB(1, 1), b3 + hstepB, voffB);
            PG8_WAIT_V(6); PG8_BAR; PG8_MMA(1, 1, At, B1); PG8_BAR;
            }
        }
        if constexpr (ALIGN_EPI) { if (wr == 0) PG8_BAR; }
        E(acc, cur, wr, wc, fr, fq);
        if (!has_next) break;
#pragma unroll
        for (int a = 0; a < 2; ++a)
#pragma unroll
            for (int b = 0; b < 2; ++b)
#pragma unroll
                for (int m = 0; m < 4; ++m)
#pragma unroll
                    for (int n = 0; n < 2; ++n) acc[a][b][m][n] = (f32x4){0.f, 0.f, 0.f, 0.f};
        cur = nxt; cA = nA; cB = nB; ++ui;
        if constexpr (ALIGN_EPI) { if (wr == 1) PG8_BAR; }
    }
    PG8_WAIT_V(0);
    if constexpr (!ALIGN_EPI) { if (wr == 0) PG8_BAR; }
    PG8_BAR;
#undef PG8_SA
#undef PG8_SB
#undef PG8_STAGE
#undef PG8_LDA
#undef PG8_LDB
#undef PG8_MMA
#undef PG8_WAIT_V
#undef PG8_WAIT_L
#undef PG8_BAR
#undef PG8_SCHED
}
}

constexpr int AT_KSTR = 272, AT_VSTR = 136, AT_KBUF = 64 * AT_KSTR, AT_VBUF = 128 * AT_VSTR;
constexpr int AT_K_OFF = 0, AT_V_OFF = 2 * AT_KBUF, AT_BIAS_OFF = AT_V_OFF + 2 * AT_VBUF;
constexpr int AT_BIAS_STR = 260;
__device__ __forceinline__ int crow(int i, int h) { return (i & 3) + 8 * (i >> 2) + 4 * h; }

template <bool WIN>
__device__ __forceinline__ void attn_core(LAS unsigned char* lds, int tid, int lane,
                                          const bf16_t* Qw, int ldq, const bf16_t* Kt, int ldk, const bf16_t* Vt, int ldv, int ntiles,
                                          bf16_t* Ow, int ldo, int rel0, const LAS float* biasT, float m_init, float l_init) {
    asm volatile("" : "+v"(lane), "+v"(tid));
    const int r = lane & 31, h = lane >> 5;
    const float c1 = 0.08838834764831845f * LOG2E;
    bf16x8 qf[8];
#pragma unroll
    for (int s = 0; s < 8; ++s) qf[s] = *(const bf16x8*)(Qw + (size_t)r * ldq + 16 * s + 8 * h);
    f32x16 o[4];
#pragma unroll
    for (int dg = 0; dg < 4; ++dg)
#pragma unroll
        for (int i = 0; i < 16; ++i) o[dg][i] = 0.f;
    float mrun = m_init, lrun = l_init;
    u32x4 kr[2], vr[2];
    const int skey0 = tid >> 4, spart = tid & 15;
#define AT_LOAD(ti) do { _Pragma("unroll") for (int j = 0; j < 2; ++j) { const int key = skey0 + 32 * j; \
        kr[j] = *(const u32x4*)(Kt + (size_t)(64 * (ti) + key) * ldk + 8 * spart); vr[j] = *(const u32x4*)(Vt + (size_t)(64 * (ti) + key) * ldv + 8 * spart); } } while (0)
#define AT_STORE(buf) do { _Pragma("unroll") for (int j = 0; j < 2; ++j) { const int key = skey0 + 32 * j; \
        *(LAS u32x4*)(lds + AT_K_OFF + (buf) * AT_KBUF + key * AT_KSTR + spart * 16) = kr[j]; \
        LAS unsigned short* vp = (LAS unsigned short*)(lds + AT_V_OFF + (buf) * AT_VBUF + (8 * spart) * AT_VSTR + key * 2); \
        vp[0 * (AT_VSTR / 2)] = (unsigned short)(vr[j].x & 0xffffu); vp[1 * (AT_VSTR / 2)] = (unsigned short)(vr[j].x >> 16); \
        vp[2 * (AT_VSTR / 2)] = (unsigned short)(vr[j].y & 0xffffu); vp[3 * (AT_VSTR / 2)] = (unsigned short)(vr[j].y >> 16); \
        vp[4 * (AT_VSTR / 2)] = (unsigned short)(vr[j].z & 0xffffu); vp[5 * (AT_VSTR / 2)] = (unsigned short)(vr[j].z >> 16); \
        vp[6 * (AT_VSTR / 2)] = (unsigned short)(vr[j].w & 0xffffu); vp[7 * (AT_VSTR / 2)] = (unsigned short)(vr[j].w >> 16); } } while (0)
    AT_LOAD(0);
    __syncthreads();
    AT_STORE(0);
    __syncthreads();
#pragma unroll 1
    for (int ti = 0; ti < ntiles; ++ti) {
        const int buf = ti & 1;
        if (ti + 1 < ntiles) AT_LOAD(ti + 1);
        const LAS unsigned char* Kb = lds + AT_K_OFF + buf * AT_KBUF;
        const LAS unsigned char* Vb = lds + AT_V_OFF + buf * AT_VBUF;
        f32x16 st[2];
#pragma unroll
        for (int kg = 0; kg < 2; ++kg)
#pragma unroll
            for (int i = 0; i < 16; ++i) st[kg][i] = 0.f;
#pragma unroll
        for (int s = 0; s < 8; ++s) {
            const bf16x8 a0 = *(const LAS bf16x8*)(Kb + r * AT_KSTR + 32 * s + 16 * h);
            const bf16x8 a1 = *(const LAS bf16x8*)(Kb + (32 + r) * AT_KSTR + 32 * s + 16 * h);
            st[0] = __builtin_amdgcn_mfma_f32_32x32x16_bf16(a0, qf[s], st[0], 0, 0, 0);
            st[1] = __builtin_amdgcn_mfma_f32_32x32x16_bf16(a1, qf[s], st[1], 0, 0, 0);
        }
        float mx = -3.0e38f;
#pragma unroll
        for (int kg = 0; kg < 2; ++kg)
#pragma unroll
            for (int i = 0; i < 16; ++i) {
                float v = st[kg][i] * c1;
                if (WIN) {
                    const int idx = rel0 + 64 * ti + 32 * kg + crow(i, h) - r + 128;
                    const bool valid = (unsigned)idx <= 256u;
                    v += biasT[valid ? idx : 0];
                    v = valid ? v : -1.0e30f;
                }
                st[kg][i] = v; mx = fmaxf(mx, v);
            }
        mx = fmaxf(mx, __shfl_xor(mx, 32));
        const float mnew = fmaxf(mrun, mx), alpha = fast_exp2(mrun - mnew);
        mrun = mnew;
        float sum = 0.f;
#pragma unroll
        for (int kg = 0; kg < 2; ++kg)
#pragma unroll
            for (int i = 0; i < 16; ++i) { const float p = fast_exp2(st[kg][i] - mnew); st[kg][i] = p; sum += p; }
        sum += __shfl_xor(sum, 32);
        lrun = lrun * alpha + sum;
#pragma unroll
        for (int dg = 0; dg < 4; ++dg)
#pragma unroll
            for (int i = 0; i < 16; ++i) o[dg][i] *= alpha;
        bf16x8 pf[2][2];
#pragma unroll
        for (int kg = 0; kg < 2; ++kg)
#pragma unroll
            for (int s2 = 0; s2 < 2; ++s2) {
                u32x4 w; w.x = pk2(st[kg][8 * s2 + 0], st[kg][8 * s2 + 1]); w.y = pk2(st[kg][8 * s2 + 2], st[kg][8 * s2 + 3]);
                w.z = pk2(st[kg][8 * s2 + 4], st[kg][8 * s2 + 5]); w.w = pk2(st[kg][8 * s2 + 6], st[kg][8 * s2 + 7]);
                pf[kg][s2] = __builtin_bit_cast(bf16x8, w);
            }
#pragma unroll
        for (int dg = 0; dg < 4; ++dg)
#pragma unroll
            for (int kg = 0; kg < 2; ++kg)
#pragma unroll
                for (int s2 = 0; s2 < 2; ++s2) {
                    const LAS unsigned char* vb = Vb + (32 * dg + r) * AT_VSTR + (32 * kg + 16 * s2 + 4 * h) * 2;
                    const s16x4 lo = *(const LAS s16x4*)vb, hi = *(const LAS s16x4*)(vb + 16);
                    const bf16x8 a = __builtin_shufflevector(lo, hi, 0, 1, 2, 3, 4, 5, 6, 7);
                    o[dg] = __builtin_amdgcn_mfma_f32_32x32x16_bf16(a, pf[kg][s2], o[dg], 0, 0, 0);
                }
        if (ti + 1 < ntiles) AT_STORE(buf ^ 1);
        __syncthreads();
    }
#undef AT_LOAD
#undef AT_STORE
    const float inv = 1.0f / lrun;
#pragma unroll
    for (int dg = 0; dg < 4; ++dg)
#pragma unroll
        for (int i4 = 0; i4 < 4; ++i4) {
            u32x2 w; w.x = pk2(o[dg][4 * i4 + 0] * inv, o[dg][4 * i4 + 1] * inv); w.y = pk2(o[dg][4 * i4 + 2] * inv, o[dg][4 * i4 + 3] * inv);
            *(u32x2*)(Ow + (size_t)r * ldo + 32 * dg + 8 * i4 + 4 * h) = w;
        }
}

__device__ __forceinline__ int t5_bucket(int rel) {
    const int n = rel < 0 ? -rel : rel;
    const int b = n < 8 ? n : 8 + (n >= 12) + (n >= 16) + (n >= 23) + (n >= 32) + (n >= 46) + (n >= 64) + (n >= 91);
    return (rel > 0 ? 16 : 0) + b;
}

struct Args { const float* in[23]; float* out; unsigned char* ws; int ph_lo, ph_hi; };
constexpr int NPH = 16;

__device__ __forceinline__ void transpose_item(const float* W, int N, int k0, int n0, bf16_t* WT, int Kd, int drow0, LAS float* scr, int lane) {
#pragma unroll 16
    for (int i = 0; i < 32; ++i) { const int kk = 2 * i + (lane >> 5); scr[kk * 33 + (lane & 31)] = W[(size_t)(k0 + kk) * N + n0 + (lane & 31)]; }
    asm volatile("s_waitcnt lgkmcnt(0)" ::: "memory");
    const int c = lane & 7;
#pragma unroll
    for (int j = 0; j < 4; ++j) { const int n = (lane >> 3) + 8 * j; const LAS float* s = scr + (8 * c) * 33 + n;
        u32x4 o; o.x = pk2(s[0 * 33], s[1 * 33]); o.y = pk2(s[2 * 33], s[3 * 33]); o.z = pk2(s[4 * 33], s[5 * 33]); o.w = pk2(s[6 * 33], s[7 * 33]);
        *(u32x4*)(WT + (size_t)(drow0 + n) * Kd + k0 + 8 * c) = o; }
    asm volatile("s_waitcnt lgkmcnt(0)" ::: "memory");
}
template <int MODE>
__device__ __forceinline__ void transpose_matrix(const float* W, int K, int N, bf16_t* WT, int row_off, LAS float* scr, int lane, int gw, int NGW) {
    const int nblk = N / 32, nitems = (K / 64) * nblk;
    for (int it = gw; it < nitems; it += NGW) {
        const int kb = it / nblk, nb = it % nblk, n0 = 32 * nb;
        int drow0;
        if (MODE == 0) drow0 = row_off + n0;
        else { const int up = n0 >= DFF, j = up ? n0 - DFF : n0; drow0 = 256 * (j / 128) + (up ? 128 : 0) + (j % 128); }
        transpose_item(W, N, 64 * kb, n0, WT, K, drow0, scr, lane);
    }
}
__device__ __forceinline__ void cvt_rows(const float* src, bf16_t* dst, size_t n, size_t gt, size_t NGT) {
    for (size_t i = gt * 8; i < n; i += NGT * 8) { const f32x4 a = *(const f32x4*)(src + i), b = *(const f32x4*)(src + i + 4);
        u32x4 w; w.x = pk2(a[0], a[1]); w.y = pk2(a[2], a[3]); w.z = pk2(b[0], b[1]); w.w = pk2(b[2], b[3]); *(u32x4*)(dst + i) = w; }
}
__device__ __forceinline__ float wave_sum(float v) {
#pragma unroll
    for (int o = 1; o < 64; o <<= 1) v += __shfl_xor(v, o);
    return v;
}
__device__ __forceinline__ void ln_rows(float* io, const float* g, const float* b, bf16_t* xb, int gw, int NGW, int lane) {
    for (int row = gw; row < T; row += NGW) {
        f32x4* p = (f32x4*)(io + (size_t)row * D) + lane;
        f32x4 v[8]; float s = 0.f;
#pragma unroll
        for (int j = 0; j < 8; ++j) { v[j] = p[64 * j]; s += (v[j][0] + v[j][1]) + (v[j][2] + v[j][3]); }
        const float mean = wave_sum(s) * (1.0f / D); float q = 0.f;
#pragma unroll
        for (int j = 0; j < 8; ++j) { v[j] = v[j] - mean; q += (v[j][0] * v[j][0] + v[j][1] * v[j][1]) + (v[j][2] * v[j][2] + v[j][3] * v[j][3]); }
        const float rstd = 1.0f / sqrtf(wave_sum(q) * (1.0f / D) + LN_EPS);
#pragma unroll
        for (int j = 0; j < 8; ++j) { const f32x4 gg = ((const f32x4*)g)[lane + 64 * j], bb = ((const f32x4*)b)[lane + 64 * j];
            const f32x4 ov = v[j] * rstd * gg + bb; p[64 * j] = ov;
            if (xb) { u32x2 w; w.x = pk2(ov[0], ov[1]); w.y = pk2(ov[2], ov[3]); *((u32x2*)(xb + (size_t)row * D) + lane + 64 * j) = w; } }
    }
}

#define P_WGU1 ((bf16_t*)(args.ws + WS_WGU1))
#define P_WD1 ((bf16_t*)(args.ws + WS_WD1))
#define P_WGU2 ((bf16_t*)(args.ws + WS_WGU2))
#define P_WD2 ((bf16_t*)(args.ws + WS_WD2))
#define P_WIG ((bf16_t*)(args.ws + WS_WIG))
#define P_WMKV ((bf16_t*)(args.ws + WS_WMKV))
#define P_WBR ((bf16_t*)(args.ws + WS_WBR))
#define P_WO ((bf16_t*)(args.ws + WS_WO))
#define P_MEMB ((bf16_t*)(args.ws + WS_MEMB))
#define P_MEMKV ((bf16_t*)(args.ws + WS_MEMKV))
#define P_XB ((bf16_t*)(args.ws + WS_XB))
#define P_HB ((bf16_t*)(args.ws + WS_BIG + BIG_H))
#define P_QKV ((bf16_t*)(args.ws + WS_BIG + BIG_QKV))
#define P_GB ((bf16_t*)(args.ws + WS_BIG + BIG_G))
#define P_YMIX ((bf16_t*)(args.ws + WS_BIG + BIG_YMIX))
#define P_MERGED ((bf16_t*)(args.ws + WS_BIG + BIG_MERGED))
__global__ void __launch_bounds__(512) fwd_kernel(Args args) {
    extern __shared__ __attribute__((aligned(16))) unsigned char lds_raw[];
    LAS unsigned char* lds = (LAS unsigned char*)lds_raw;
    cg::grid_group grid = cg::this_grid();
    const int tid = threadIdx.x, lane = tid & 63, wave = __builtin_amdgcn_readfirstlane(tid >> 6);
    const int G = gridDim.x, bid = blockIdx.x;
    const int gw = bid * 8 + wave, NGW = G * 8;
    float* out = args.out;
    const int lo = args.ph_lo, hi = args.ph_hi;
#define IN(k) (lo <= (k) && (k) < hi)
#define SEAM(k) do { if (IN(k) && IN((k) + 1)) grid.sync(); } while (0)

    if (IN(0)) {
        LAS float* scr = (LAS float*)(lds + wave * 16384);
        transpose_matrix<1>(args.in[7], D, NGU, P_WGU1, 0, scr, lane, gw, NGW);
        transpose_matrix<0>(args.in[8], DFF, D, P_WD1, 0, scr, lane, gw, NGW);
        transpose_matrix<1>(args.in[19], D, NGU, P_WGU2, 0, scr, lane, gw, NGW);
        transpose_matrix<0>(args.in[20], DFF, D, P_WD2, 0, scr, lane, gw, NGW);
        transpose_matrix<0>(args.in[9], D, DIN, P_WIG, 0, scr, lane, gw, NGW);
        transpose_matrix<0>(args.in[13], D, NGATE, P_WIG, DIN, scr, lane, gw, NGW);
        transpose_matrix<0>(args.in[11], D, DMKV, P_WMKV, 0, scr, lane, gw, NGW);
        transpose_matrix<0>(args.in[15], D, D, P_WBR, 0, scr, lane, gw, NGW);
        transpose_matrix<0>(args.in[16], D, D, P_WO, 0, scr, lane, gw, NGW);
        const size_t gt = (size_t)bid * 512 + tid, NGT = (size_t)G * 512;
        cvt_rows(args.in[0], P_XB, (size_t)T_P * D, gt, NGT);
        cvt_rows(args.in[1], P_XB + (size_t)T_P * D, (size_t)T_S * D, gt, NGT);
        cvt_rows(args.in[2], P_MEMB, (size_t)16 * NMEM * D, gt, NGT);
        cvt_rows(args.in[3], P_MEMB + (size_t)16 * NMEM * D, (size_t)2 * NMEM * D, gt, NGT);
    }
    SEAM(0);
    if (IN(1)) {
        { pg8::Gemm g{P_XB, P_WGU1, D, D, T, NGU, D}; pg8::StaticOrder S; S.init(T, NGU, G, bid); pg8::EpiSwiGLU E{P_HB};
          pg8::gemm_phase<pg8::EpiSwiGLU, pg8::StaticOrder, true, true>(lds, g, S, E); }
        { pg8::Gemm g{P_MEMB, P_WMKV, D, D, MEM_ROWS, DMKV, D}; pg8::StaticOrder S; S.init(MEM_ROWS, DMKV, 72, G >= 136 ? bid - 64 : bid); pg8::EpiBf16 E{P_MEMKV, DMKV};
          pg8::gemm_phase<pg8::EpiBf16, pg8::StaticOrder, true, true>(lds, g, S, E); }
    }
    SEAM(1);
    if (IN(2)) {
        pg8::Gemm g{P_HB, P_WD1, DFF, DFF, T, D, DFF}; pg8::StaticOrder S; S.init(T, D, G, bid); pg8::EpiRes E{args.in[0], args.in[1], T_P, out, 0.5f, 0};
        pg8::gemm_phase<pg8::EpiRes, pg8::StaticOrder, true, true>(lds, g, S, E);
    }
    SEAM(2);
    if (IN(3)) ln_rows(out, args.in[5], args.in[6], P_XB, gw, NGW, lane);
    SEAM(3);
#pragma unroll 1
    for (int ch = 0; ch < NCHUNK; ++ch) {
        const int pb = 4 + 4 * ch, row_c0 = ch * CH_ROWS;
        if (IN(pb)) {
            pg8::Gemm g{P_XB + (size_t)row_c0 * D, P_WIG, D, D, CH_ROWS, NIG, D}; pg8::StaticOrder S; S.init(CH_ROWS, NIG, G, bid); pg8::EpiInGate E{P_QKV, P_GB, args.in[14]};
            pg8::gemm_phase<pg8::EpiInGate, pg8::StaticOrder, true, true>(lds, g, S, E);
        }
        SEAM(pb);
        if (IN(pb + 1)) {
            LAS float* btab = (LAS float*)(lds + AT_BIAS_OFF);
            const float* rbt = args.in[4];
            for (int i = tid; i < 8 * 257; i += 512) { const int hd = i / 257, ri = i % 257; btab[hd * AT_BIAS_STR + ri] = rbt[t5_bucket(ri - 128) * 8 + hd] * LOG2E; }
            __syncthreads();
            constexpr int NWU = (CH_ROWS / 64) * 2, NMU = (CH_ROWS / 256) * 4;
            for (int ui = bid; ui < NWU + NMU; ui += G) {
                if (ui < NWU) {
                    const int hk = ui & 1, qb = ui >> 1;
                    const int lrow0 = qb * 64, grow0 = row_c0 + lrow0;
                    int seq0, S_;
                    if (grow0 < T_P) { seq0 = (grow0 / SEQ_P) * SEQ_P; S_ = SEQ_P; } else { seq0 = T_P + ((grow0 - T_P) / SEQ_S) * SEQ_S; S_ = SEQ_S; }
                    const int pos0 = grow0 - seq0;
                    int klo = pos0 - 128, khi = pos0 + 192;
                    if (klo < 0) klo = 0; if (khi > S_) khi = S_;
                    const int ntiles = (khi - klo) / 64;
                    const int g4 = wave >> 1, qs = wave & 1, hq = hk * 4 + g4;
                    const int lq = lrow0 + 32 * qs;
                    const bf16_t* Qw = P_QKV + (size_t)lq * DIN + C_Q + hq * 128;
                    const int lkey0 = lrow0 - pos0 + klo;
                    const bf16_t* Kt = P_QKV + (size_t)lkey0 * DIN + C_K + hk * 128;
                    const bf16_t* Vt = P_QKV + (size_t)lkey0 * DIN + C_V + hk * 128;
                    bf16_t* Ow = P_YMIX + (size_t)lq * D + hq * 128;
                    const float sink2 = args.in[12][hq] * LOG2E;
                    attn_core<true>(lds, tid, lane, Qw, DIN, Kt, DIN, Vt, DIN, ntiles, Ow, D, klo - (pos0 + 32 * qs), btab + hq * AT_BIAS_STR, sink2, 1.0f);
                } else {
                    const int mu = ui - NWU, hx = mu & 3, rb = mu >> 2;
                    const int lrow0 = rb * 256, grow0 = row_c0 + lrow0;
                    const int mi = grow0 < T_P ? grow0 / SEQ_P : 16 + (grow0 - T_P) / SEQ_S;
                    const int lq = lrow0 + 32 * wave;
                    const bf16_t* Qw = P_QKV + (size_t)lq * DIN + C_QX + hx * 128;
                    const bf16_t* Kt = P_MEMKV + (size_t)mi * NMEM * DMKV + hx * 128;
                    const bf16_t* Vt = Kt + 512;
                    bf16_t* Ow = P_YMIX + (size_t)lq * D + 1536 + hx * 128;
                    attn_core<false>(lds, tid, lane, Qw, DIN, Kt, DMKV, Vt, DMKV, 4, Ow, D, 0, btab, -1.0e30f, 0.0f);
                }
            }
            const float* cw = args.in[10];
            for (int idx = bid * 512 + tid; idx < CH_ROWS * 64; idx += G * 512) {
                const int lt = idx >> 6, c8 = (idx & 63) * 8, gt_ = row_c0 + lt;
                int pos, S_;
                if (gt_ < T_P) { pos = gt_ % SEQ_P; S_ = SEQ_P; } else { pos = (gt_ - T_P) % SEQ_S; S_ = SEQ_S; }
                const bf16_t* rp = P_QKV + (size_t)lt * DIN;
                const u32x4 cb = *(const u32x4*)(rp + C_CB + c8), cc1 = *(const u32x4*)(rp + C_CC + c8), ch1 = *(const u32x4*)(rp + C_CH + c8);
                u32x4 cc0 = {0u, 0u, 0u, 0u}, ch0 = cc0, cc2 = cc0, ch2 = cc0;
                if (pos > 0) { cc0 = *(const u32x4*)(rp - DIN + C_CC + c8); ch0 = *(const u32x4*)(rp - DIN + C_CH + c8); }
                if (pos < S_ - 1) { cc2 = *(const u32x4*)(rp + DIN + C_CC + c8); ch2 = *(const u32x4*)(rp + DIN + C_CH + c8); }
                const f32x4 w0a = *(const f32x4*)(cw + c8), w0b = *(const f32x4*)(cw + c8 + 4), w1a = *(const f32x4*)(cw + 512 + c8), w1b = *(const f32x4*)(cw + 512 + c8 + 4),
                            w2a = *(const f32x4*)(cw + 1024 + c8), w2b = *(const f32x4*)(cw + 1024 + c8 + 4);
                float y[8];
#define CONV_E(e, W, A0, A1, A2, B0, B1, B2, CBW, LH) y[e] = LH(CBW) * (W##0 * (LH(A0) * LH(B0)) + W##1 * (LH(A1) * LH(B1)) + W##2 * (LH(A2) * LH(B2)))
                { const float a0 = w0a[0], a1 = w1a[0], a2 = w2a[0]; y[0] = bf_lo(cb.x) * (a0 * (bf_lo(cc0.x) * bf_lo(ch0.x)) + a1 * (bf_lo(cc1.x) * bf_lo(ch1.x)) + a2 * (bf_lo(cc2.x) * bf_lo(ch2.x))); }
                { const float a0 = w0a[1], a1 = w1a[1], a2 = w2a[1]; y[1] = bf_hi(cb.x) * (a0 * (bf_hi(cc0.x) * bf_hi(ch0.x)) + a1 * (bf_hi(cc1.x) * bf_hi(ch1.x)) + a2 * (bf_hi(cc2.x) * bf_hi(ch2.x))); }
                { const float a0 = w0a[2], a1 = w1a[2], a2 = w2a[2]; y[2] = bf_lo(cb.y) * (a0 * (bf_lo(cc0.y) * bf_lo(ch0.y)) + a1 * (bf_lo(cc1.y) * bf_lo(ch1.y)) + a2 * (bf_lo(cc2.y) * bf_lo(ch2.y))); }
                { const float a0 = w0a[3], a1 = w1a[3], a2 = w2a[3]; y[3] = bf_hi(cb.y) * (a0 * (bf_hi(cc0.y) * bf_hi(ch0.y)) + a1 * (bf_hi(cc1.y) * bf_hi(ch1.y)) + a2 * (bf_hi(cc2.y) * bf_hi(ch2.y))); }
                { const float a0 = w0b[0], a1 = w1b[0], a2 = w2b[0]; y[4] = bf_lo(cb.z) * (a0 * (bf_lo(cc0.z) * bf_lo(ch0.z)) + a1 * (bf_lo(cc1.z) * bf_lo(ch1.z)) + a2 * (bf_lo(cc2.z) * bf_lo(ch2.z))); }
                { const float a0 = w0b[1], a1 = w1b[1], a2 = w2b[1]; y[5] = bf_hi(cb.z) * (a0 * (bf_hi(cc0.z) * bf_hi(ch0.z)) + a1 * (bf_hi(cc1.z) * bf_hi(ch1.z)) + a2 * (bf_hi(cc2.z) * bf_hi(ch2.z))); }
                { const float a0 = w0b[2], a1 = w1b[2], a2 = w2b[2]; y[6] = bf_lo(cb.w) * (a0 * (bf_lo(cc0.w) * bf_lo(ch0.w)) + a1 * (bf_lo(cc1.w) * bf_lo(ch1.w)) + a2 * (bf_lo(cc2.w) * bf_lo(ch2.w))); }
                { const float a0 = w0b[3], a1 = w1b[3], a2 = w2b[3]; y[7] = bf_hi(cb.w) * (a0 * (bf_hi(cc0.w) * bf_hi(ch0.w)) + a1 * (bf_hi(cc1.w) * bf_hi(ch1.w)) + a2 * (bf_hi(cc2.w) * bf_hi(ch2.w))); }
#undef CONV_E
                u32x4 w; w.x = pk2(y[0], y[1]); w.y = pk2(y[2], y[3]); w.z = pk2(y[4], y[5]); w.w = pk2(y[6], y[7]);
                *(u32x4*)(P_YMIX + (size_t)lt * D + 1024 + c8) = w;
            }
        }
        SEAM(pb + 1);
        if (IN(pb + 2)) {
            { pg8::Gemm g{P_YMIX, P_WBR, D, D, CH_ROWS, D, 1024}; pg8::StaticOrder S; S.init(CH_ROWS, D, G, bid); pg8::EpiBranch E{P_GB, P_MERGED, 0};
              pg8::gemm_phase<pg8::EpiBranch, pg8::StaticOrder, true, true>(lds, g, S, E); }
            { pg8::Gemm g{P_YMIX + 1024, P_WBR + 1024, D, D, CH_ROWS, D, 512}; pg8::StaticOrder S; S.init(CH_ROWS, D, G, bid); pg8::EpiBranch E{P_GB, P_MERGED, 1};
              pg8::gemm_phase<pg8::EpiBranch, pg8::StaticOrder, true, true>(lds, g, S, E); }
            { pg8::Gemm g{P_YMIX + 1536, P_WBR + 1536, D, D, CH_ROWS, D, 512}; pg8::StaticOrder S; S.init(CH_ROWS, D, G, bid); pg8::EpiBranch E{P_GB, P_MERGED, 2};
              pg8::gemm_phase<pg8::EpiBranch, pg8::StaticOrder, true, true>(lds, g, S, E); }
        }
        SEAM(pb + 2);
        if (IN(pb + 3)) {
            pg8::Gemm g{P_MERGED, P_WO, D, D, CH_ROWS, D, D}; pg8::StaticOrder S; S.init(CH_ROWS, D, G, bid); pg8::EpiRes E{out, out + (size_t)T_P * D, T_P, out, 1.0f, row_c0};
            pg8::gemm_phase<pg8::EpiRes, pg8::StaticOrder, true, true>(lds, g, S, E);
        }
        SEAM(pb + 3);
    }
    if (IN(12)) ln_rows(out, args.in[17], args.in[18], P_XB, gw, NGW, lane);
    SEAM(12);
    if (IN(13)) {
        pg8::Gemm g{P_XB, P_WGU2, D, D, T, NGU, D}; pg8::StaticOrder S; S.init(T, NGU, G, bid); pg8::EpiSwiGLU E{P_HB};
        pg8::gemm_phase<pg8::EpiSwiGLU, pg8::StaticOrder, true, true>(lds, g, S, E);
    }
    SEAM(13);
    if (IN(14)) {
        pg8::Gemm g{P_HB, P_WD2, DFF, DFF, T, D, DFF}; pg8::StaticOrder S; S.init(T, D, G, bid); pg8::EpiRes E{out, out + (size_t)T_P * D, T_P, out, 0.5f, 0};
        pg8::gemm_phase<pg8::EpiRes, pg8::StaticOrder, true, true>(lds, g, S, E);
    }
    SEAM(14);
    if (IN(15)) ln_rows(out, args.in[21], args.in[22], nullptr, gw, NGW, lane);
#undef IN
#undef SEAM
}

#ifndef N_LAUNCH_MODE
#define N_LAUNCH_MODE 0
#endif

extern "C" void kernel_launch(void* const* d_in, const int* in_sizes, int n_in, void* d_out, int out_size, void* d_ws, size_t ws_size, hipStream_t stream) {
    static int grid = 0;
    if (grid == 0) {
        if (n_in != 23 || out_size != T * D || ws_size < WS_END) { fprintf(stderr, "kernel_launch: unexpected shapes (n_in %d, out %d, ws %zu)\n", n_in, out_size, ws_size); grid = -1; return; }
        int dev = 0, cus = 0, per_cu = 0;
        hipGetDevice(&dev);
        hipDeviceGetAttribute(&cus, hipDeviceAttributeMultiprocessorCount, dev);
        if (hipFuncSetAttribute((const void*)fwd_kernel, hipFuncAttributeMaxDynamicSharedMemorySize, LDS_BYTES) != hipSuccess) { fprintf(stderr, "kernel_launch: hipFuncSetAttribute failed\n"); grid = -1; return; }
        if (hipOccupancyMaxActiveBlocksPerMultiprocessor(&per_cu, (const void*)fwd_kernel, 512, LDS_BYTES) != hipSuccess || per_cu < 1) { fprintf(stderr, "kernel_launch: occupancy query failed (%d)\n", per_cu); per_cu = 1; }
        (void)hipGetLastError();
        grid = cus * per_cu;
        fprintf(stderr, "kernel_launch: grid %d (cus %d x %d)\n", grid, cus, per_cu);
    }
    if (grid < 0) return;
    Args a{};
    for (int i = 0; i < 23; ++i) a.in[i] = (const float*)d_in[i];
    a.out = (float*)d_out; a.ws = (unsigned char*)d_ws;
#if N_LAUNCH_MODE == 0
    for (int p = 0; p < NPH; ++p) {
        a.ph_lo = p; a.ph_hi = p + 1;
        hipLaunchKernelGGL(fwd_kernel, dim3(grid), dim3(512), LDS_BYTES, stream, a);
    }
#else
    a.ph_lo = 0; a.ph_hi = NPH;
    void* kargs[] = {&a};
    hipError_t e = hipLaunchCooperativeKernel((const void*)fwd_kernel, dim3(grid), dim3(512), kargs, LDS_BYTES, stream);
    if (e != hipSuccess) fprintf(stderr, "kernel_launch: cooperative launch failed: %s (grid %d)\n", hipGetErrorString(e), grid);
#endif
}
```
